# Optimizing an MI355X kernel written in HIP

```python
import math
import jax, jax.numpy as jnp
from jax import lax
import numpy as np

D_MODEL = 2048
BATCH = 1
SEQ = 16384
DEPTH = 4

N_A_LAYERS = DEPTH // 2
N_B_LAYERS = DEPTH - N_A_LAYERS
CHUNK = 128
A_WIDTH = D_MODEL
A_GROUPS = 8
A_GROUP_DIM = A_WIDTH // A_GROUPS
HEAD_DIM = 64
N_Q_HEADS = D_MODEL // HEAD_DIM
N_KV_HEADS = 4
Q_PER_KV = N_Q_HEADS // N_KV_HEADS
WINDOW = 128
ROPE_THETA = 10000.0
D_FF = 4 * D_MODEL
LN_EPS = 1e-5
DEEPNORM_ALPHA = (2.0 * DEPTH) ** 0.25
DEEPNORM_BETA = (8.0 * DEPTH) ** -0.25

kernel_name = "yoco_sgu_swa_sink_deepnorm_trunk"


def layer_norm(x, g, b):
    xf = x.astype(jnp.float32)
    mu = jnp.mean(xf, axis=-1, keepdims=True)
    var = jnp.mean(jnp.square(xf - mu), axis=-1, keepdims=True)
    y = (xf - mu) * lax.rsqrt(var + LN_EPS) * g.astype(jnp.float32) + b.astype(jnp.float32)
    return y.astype(x.dtype)


def rope(t, positions):
    hd = t.shape[-1]
    inv_freq = ROPE_THETA ** (-jnp.arange(0, hd, 2, dtype=jnp.float32) / hd)
    ang = positions.astype(jnp.float32)[:, None] * inv_freq[None, :]
    cos = jnp.cos(ang)[None, :, None, :]
    sin = jnp.sin(ang)[None, :, None, :]
    tf = t.astype(jnp.float32)
    t1, t2 = tf[..., : hd // 2], tf[..., hd // 2:]
    out = jnp.concatenate([t1 * cos - t2 * sin, t2 * cos + t1 * sin], axis=-1)
    return out.astype(t.dtype)


def chunked_sgu(x, w_in, b_in, ln_v_g, ln_v_b, w_s, b_s, w_out):
    B, S, _ = x.shape
    nc = S // CHUNK
    z = jax.nn.gelu(x @ w_in + b_in, approximate=False)
    u, v = jnp.split(z, 2, axis=-1)
    v = layer_norm(v, ln_v_g, ln_v_b)
    v = v.reshape(B, nc, CHUNK, A_GROUPS, A_GROUP_DIM)
    causal = jnp.tril(jnp.ones((CHUNK, CHUNK), dtype=w_s.dtype))
    ws = w_s * causal[None]
    s = jnp.einsum('gij,bnjgd->bnigd', ws, v) + b_s.T[None, None, :, :, None]
    y = u * s.reshape(B, S, A_WIDTH)
    return y @ w_out


def shared_kv_bands(x_kv, w_kv, b_kv, positions):
    B, S, _ = x_kv.shape
    nb = S // WINDOW
    kv = x_kv @ w_kv + b_kv
    k, v = jnp.split(kv, 2, axis=-1)
    k = rope(k.reshape(B, S, N_KV_HEADS, HEAD_DIM), positions)
    v = v.reshape(B, S, N_KV_HEADS, HEAD_DIM)

    def band(t):
        blk = t.reshape(B, nb, WINDOW, N_KV_HEADS, HEAD_DIM)
        prev = jnp.pad(blk[:, :-1], ((0, 0), (1, 0), (0, 0), (0, 0), (0, 0)))
        return jnp.concatenate([prev, blk], axis=2)

    return band(k), band(v)


def sliding_sink_attention(x, k_band, v_band, w_q, b_q, sinks, w_o, positions):
    B, S, _ = x.shape
    nb = S // WINDOW
    q = rope((x @ w_q + b_q).reshape(B, S, N_Q_HEADS, HEAD_DIM), positions)
    q = q.reshape(B, nb, WINDOW, N_KV_HEADS, Q_PER_KV, HEAD_DIM)
    scores = jnp.einsum('bnqhgd,bnkhd->bnhgqk', q, k_band).astype(jnp.float32)
    scores = scores * (HEAD_DIM ** -0.5)
    i = jnp.arange(WINDOW)[:, None]
    j = jnp.arange(2 * WINDOW)[None, :]
    in_band = (j > i) & (j <= i + WINDOW)
    blk = jnp.arange(nb)[:, None, None]
    valid = in_band[None] & ((blk > 0) | (j[None] >= WINDOW))
    scores = jnp.where(valid[None, :, None, None], scores, jnp.finfo(jnp.float32).min)
    sink = jnp.broadcast_to(
        sinks.astype(jnp.float32).reshape(1, 1, N_KV_HEADS, Q_PER_KV, 1, 1),
        scores.shape[:-1] + (1,))
    p = jax.nn.softmax(jnp.concatenate([scores, sink], axis=-1), axis=-1)[..., :-1]
    o = jnp.einsum('bnhgqk,bnkhd->bnqhgd', p.astype(v_band.dtype), v_band)
    return o.reshape(B, S, N_Q_HEADS * HEAD_DIM) @ w_o


def sq_relu_mlp(x, w_up, w_down):
    return jnp.square(jax.nn.relu(x @ w_up)) @ w_down


def setup_inputs(seed: int = 0) -> dict:
    key = jax.random.key(seed)
    ks = jax.random.split(key, 20)
    f32 = jnp.float32

    def nrm(k, shape, scale):
        return jax.random.normal(k, shape, f32) * scale

    x = jax.random.normal(ks[0], (BATCH, SEQ, D_MODEL), f32)
    a_w_in = nrm(ks[1], (N_A_LAYERS, D_MODEL, 2 * A_WIDTH), D_MODEL ** -0.5)
    a_b_in = nrm(ks[2], (N_A_LAYERS, 2 * A_WIDTH), 0.02)
    a_ln_v_g = 1.0 + nrm(ks[3], (N_A_LAYERS, A_WIDTH), 0.02)
    a_ln_v_b = nrm(ks[4], (N_A_LAYERS, A_WIDTH), 0.02)
    a_w_s = nrm(ks[5], (N_A_LAYERS, A_GROUPS, CHUNK, CHUNK), CHUNK ** -0.5)
    a_b_s = 1.0 + nrm(ks[6], (N_A_LAYERS, A_GROUPS, CHUNK), 0.1)
    a_w_out = nrm(ks[7], (N_A_LAYERS, A_WIDTH, D_MODEL), DEEPNORM_BETA * A_WIDTH ** -0.5)
    w_k = nrm(ks[8], (D_MODEL, N_KV_HEADS * HEAD_DIM), D_MODEL ** -0.5)
    w_v = nrm(ks[9], (D_MODEL, N_KV_HEADS * HEAD_DIM), DEEPNORM_BETA * D_MODEL ** -0.5)
    kv_w = jnp.concatenate([w_k, w_v], axis=-1)
    kv_b = nrm(ks[10], (2 * N_KV_HEADS * HEAD_DIM,), 0.02)
    b_w_q = nrm(ks[11], (N_B_LAYERS, D_MODEL, N_Q_HEADS * HEAD_DIM), D_MODEL ** -0.5)
    b_b_q = nrm(ks[12], (N_B_LAYERS, N_Q_HEADS * HEAD_DIM), 0.02)
    b_sinks = nrm(ks[13], (N_B_LAYERS, N_Q_HEADS), 1.0)
    b_w_o = nrm(ks[14], (N_B_LAYERS, N_Q_HEADS * HEAD_DIM, D_MODEL),
                DEEPNORM_BETA * (N_Q_HEADS * HEAD_DIM) ** -0.5)
    mlp_w_up = nrm(ks[15], (DEPTH, D_MODEL, D_FF), DEEPNORM_BETA * D_MODEL ** -0.5)
    mlp_w_down = nrm(ks[16], (DEPTH, D_FF, D_MODEL), DEEPNORM_BETA * D_FF ** -0.5)
    ln_g = 1.0 + nrm(ks[17], (DEPTH, 2, D_MODEL), 0.02)
    ln_b = nrm(ks[18], (DEPTH, 2, D_MODEL), 0.02)
    return {"x": x, "a_w_in": a_w_in, "a_b_in": a_b_in, "a_ln_v_g": a_ln_v_g,
            "a_ln_v_b": a_ln_v_b, "a_w_s": a_w_s, "a_b_s": a_b_s, "a_w_out": a_w_out,
            "kv_w": kv_w, "kv_b": kv_b, "b_w_q": b_w_q, "b_b_q": b_b_q,
            "b_sinks": b_sinks, "b_w_o": b_w_o, "mlp_w_up": mlp_w_up,
            "mlp_w_down": mlp_w_down, "ln_g": ln_g, "ln_b": ln_b}


def reference(x, a_w_in, a_b_in, a_ln_v_g, a_ln_v_b, a_w_s, a_b_s, a_w_out,
              kv_w, kv_b, b_w_q, b_b_q, b_sinks, b_w_o, mlp_w_up, mlp_w_down,
              ln_g, ln_b):
    S = x.shape[1]
    positions = jnp.arange(S, dtype=jnp.int32)
    k_band = v_band = None
    for layer in range(DEPTH):
        if layer < N_A_LAYERS:
            mix = chunked_sgu(x, a_w_in[layer], a_b_in[layer], a_ln_v_g[layer],
                              a_ln_v_b[layer], a_w_s[layer], a_b_s[layer], a_w_out[layer])
        else:
            if layer == N_A_LAYERS:
                k_band, v_band = shared_kv_bands(x, kv_w, kv_b, positions)
            j = layer - N_A_LAYERS
            mix = sliding_sink_attention(x, k_band, v_band, b_w_q[j], b_b_q[j],
                                         b_sinks[j], b_w_o[j], positions)
        x = layer_norm(DEEPNORM_ALPHA * x + mix, ln_g[layer, 0], ln_b[layer, 0])
        x = layer_norm(DEEPNORM_ALPHA * x + sq_relu_mlp(x, mlp_w_up[layer], mlp_w_down[layer]),
                       ln_g[layer, 1], ln_b[layer, 1])
    return x
```

```cpp
#include <hip/hip_runtime.h>
#include <hip/hip_cooperative_groups.h>
#include <cstdio>
#include <cstdint>
namespace cg = cooperative_groups;

#ifndef EN_ALL
#define EN_ALL 1
#endif
#ifndef EN_IN
#define EN_IN EN_ALL
#endif
#ifndef EN_SGU
#define EN_SGU EN_ALL
#endif
#ifndef EN_QKV
#define EN_QKV EN_ALL
#endif
#ifndef EN_ATT
#define EN_ATT EN_ALL
#endif
#ifndef EN_RES
#define EN_RES EN_ALL
#endif
#ifndef EN_LN
#define EN_LN EN_ALL
#endif
#ifndef EN_UP
#define EN_UP EN_ALL
#endif
#ifndef EN_PRO
#define EN_PRO EN_ALL
#endif

#define LAS __attribute__((address_space(3)))
typedef unsigned short bf16_t;
typedef short bf16x8 __attribute__((ext_vector_type(8)));
typedef short s16x4 __attribute__((ext_vector_type(4)));
typedef float f32x4 __attribute__((ext_vector_type(4)));
typedef float f32x2 __attribute__((ext_vector_type(2)));
typedef unsigned u32x4 __attribute__((ext_vector_type(4)));
typedef unsigned u32x2 __attribute__((ext_vector_type(2)));

constexpr int S_ = 16384, D_ = 2048, FF_ = 8192, ZW_ = 4096;
constexpr float ALPHA = 1.6817928305074290f;
constexpr float LN_EPS = 1e-5f;
constexpr float LOG2E = 1.4426950408889634f;

constexpr size_t WS_WIN = 4096;
constexpr size_t WS_WOUT = WS_WIN + (size_t)2 * 4096 * 2048 * 2;
constexpr size_t WS_WKV = WS_WOUT + (size_t)2 * 2048 * 2048 * 2;
constexpr size_t WS_WQ = WS_WKV + (size_t)512 * 2048 * 2;
constexpr size_t WS_WO = WS_WQ + (size_t)2 * 2048 * 2048 * 2;
constexpr size_t WS_WUP = WS_WO + (size_t)2 * 2048 * 2048 * 2;
constexpr size_t WS_WDN = WS_WUP + (size_t)4 * 8192 * 2048 * 2;
constexpr size_t WS_WS = WS_WDN + (size_t)4 * 8192 * 2048 * 2;
constexpr size_t WS_XB = WS_WS + (size_t)2 * 8 * 128 * 128 * 2;
constexpr size_t WS_ST = WS_XB + (size_t)S_ * D_ * 2;
constexpr size_t WS_ROPE = WS_ST + (size_t)S_ * 8;
constexpr size_t WS_VPART = WS_ROPE + (size_t)S_ * 32 * 8;
constexpr size_t WS_KB = WS_VPART + (size_t)S_ * 32 * 8;
constexpr size_t WS_VB = WS_KB + (size_t)S_ * 256 * 2;
constexpr size_t WS_Y = WS_VB + (size_t)S_ * 256 * 2;
constexpr size_t WS_H = WS_Y + (size_t)S_ * D_ * 2;
constexpr size_t WS_END = WS_H + (size_t)S_ * FF_ * 2;
constexpr int LDS_BYTES = 131072;

__device__ __forceinline__ unsigned cvt_pk_bf16(float lo, float hi) { unsigned r; asm volatile("v_cvt_pk_bf16_f32 %0, %1, %2" : "=v"(r) : "v"(lo), "v"(hi)); return r; }
__device__ __forceinline__ float bf_lo(unsigned w) { return __uint_as_float(w << 16); }
__device__ __forceinline__ float bf_hi(unsigned w) { return __uint_as_float(w & 0xffff0000u); }

namespace pg8 {
constexpr int BM = 256, BK = 64, HALF = 128, HTB = HALF * BK * 2, STAGE_BYTES = 8 * HTB, NXCD = 8, WGM = 8;
__host__ __device__ __forceinline__ int lds_byte(int r, int c) { const int st = (r >> 4) * 2 + (c >> 5), rr = r & 15, cc = c & 31, ob = rr * 64 + cc * 2; return st * 1024 + (ob ^ (((ob >> 9) & 1) << 5)); }
__host__ __device__ __forceinline__ void stage_rc(int b, int& R, int& C) { const int st = b / 1024, sb = b % 1024, swz = sb ^ (((sb >> 9) & 1) << 5); R = (st >> 1) * 16 + swz / 64; C = (st & 1) * 32 + (swz % 64) / 2; }
__host__ __device__ __forceinline__ int perm32(int rho) { const int n = rho >> 4, i = rho & 15; return 8 * (i >> 2) + 4 * n + (i & 3); }

struct Unit { int pm, pn; };
struct Gemm { const bf16_t* A; const bf16_t* Bt; int M, N, K; };

struct StaticOrder {
    int nM, nN, nwg, G, c;
    __host__ __device__ void init(int M, int N, int G_, int c_) { nM = M / BM; nN = N / BM; nwg = nM * nN; G = G_; c = c_; }
    __host__ __device__ bool next(int i, Unit& u) const {
        const long L = (long)i * G + c; if (L >= nwg) return false;
        int wgid = (int)L; { const int q = nwg / NXCD, r = nwg % NXCD, xcd = wgid % NXCD, off = wgid / NXCD; wgid = (xcd < r ? xcd * (q + 1) : r * (q + 1) + (xcd - r) * q) + off; }
        const int nig = WGM * nN, gid = wgid / nig, fm = gid * WGM, gsz = (nM - fm) < WGM ? (nM - fm) : WGM;
        u.pm = fm + ((wgid % nig) % gsz); u.pn = (wgid % nig) / gsz; return true;
    }
    __device__ __forceinline__ void a_ready(const Unit&) const {}
    __device__ __forceinline__ void done(const Unit&) const {}
};

__device__ __forceinline__ f32x2 gelu_pk(f32x2 v) {
    const f32x2 av = __builtin_elementwise_abs(v), d = av * 0.2316418882f + 1.0f;
    f32x2 t; t.x = __builtin_amdgcn_rcpf(d.x); t.y = __builtin_amdgcn_rcpf(d.y);
    f32x2 q = t * 0.5307027145f + (-0.7265760135f); q = q * t + 0.7107068705f; q = q * t + (-0.142248368f); q = q * t + 0.127414796f; q = q * t;
    const f32x2 s = (v * v) * (-0.72134752044f);
    f32x2 e; e.x = __builtin_amdgcn_exp2f(s.x); e.y = __builtin_amdgcn_exp2f(s.y);
    const f32x2 m = v * (q * e), r = v - m;
    f32x2 o; o.x = v.x < 0.f ? m.x : r.x; o.y = v.y < 0.f ? m.y : r.y; return o;
}


struct EpiGeluZ {
    static constexpr bool PERM = true, AFTER_DRAIN = false;
    bf16_t* Z; const float* bias; f32x2* vpart;
    __device__ __forceinline__ void operator()(const f32x4 (&acc)[2][2][4][2], const Unit& u, int wr, int wc, int fr, int fq) const {
        const int row0 = u.pm * BM + wr * 64 + fr, col0 = u.pn * BM + wc * 32 + 8 * fq;
        const bool isv = u.pn >= 8;
        f32x4 bv[2][2];
#pragma unroll
        for (int bj = 0; bj < 2; ++bj)
#pragma unroll
            for (int n = 0; n < 2; ++n) bv[bj][n] = *(const f32x4*)(bias + col0 + bj * HALF + 4 * n);
#pragma unroll
        for (int ai = 0; ai < 2; ++ai)
#pragma unroll
            for (int m = 0; m < 4; ++m) { const int row = row0 + ai * HALF + m * 16; bf16_t* rowp = Z + (size_t)row * ZW_ + col0; float s = 0.f, q = 0.f;
#pragma unroll
                for (int bj = 0; bj < 2; ++bj) { f32x4 v0 = acc[ai][bj][m][0] + bv[bj][0], v1 = acc[ai][bj][m][1] + bv[bj][1];
                    f32x2 a = gelu_pk((f32x2){v0[0], v0[1]}), b = gelu_pk((f32x2){v0[2], v0[3]}), c = gelu_pk((f32x2){v1[0], v1[1]}), d = gelu_pk((f32x2){v1[2], v1[3]});
                    s += (a.x + a.y) + (b.x + b.y) + (c.x + c.y) + (d.x + d.y);
                    q += (a.x * a.x + a.y * a.y) + (b.x * b.x + b.y * b.y) + (c.x * c.x + c.y * c.y) + (d.x * d.x + d.y * d.y);
                    u32x4 w; w.x = cvt_pk_bf16(a.x, a.y); w.y = cvt_pk_bf16(b.x, b.y); w.z = cvt_pk_bf16(c.x, c.y); w.w = cvt_pk_bf16(d.x, d.y);
                    *(u32x4*)(rowp + bj * HALF) = w; }
                if (isv) { s += __shfl_xor(s, 16); s += __shfl_xor(s, 32); q += __shfl_xor(q, 16); q += __shfl_xor(q, 32);
                    if (fq == 0) vpart[(size_t)row * 32 + (u.pn - 8) * 4 + wc] = (f32x2){s, q}; } }
    }
};
struct EpiRelu2 {
    static constexpr bool PERM = true, AFTER_DRAIN = false;
    bf16_t* H;
    __device__ __forceinline__ void operator()(const f32x4 (&acc)[2][2][4][2], const Unit& u, int wr, int wc, int fr, int fq) const {
        const int row0 = u.pm * BM + wr * 64 + fr, col0 = u.pn * BM + wc * 32 + 8 * fq;
#pragma unroll
        for (int ai = 0; ai < 2; ++ai)
#pragma unroll
            for (int m = 0; m < 4; ++m) { bf16_t* rowp = H + (size_t)(row0 + ai * HALF + m * 16) * FF_ + col0;
#pragma unroll
                for (int bj = 0; bj < 2; ++bj) { f32x4 v0 = acc[ai][bj][m][0], v1 = acc[ai][bj][m][1];
#pragma unroll
                    for (int j = 0; j < 4; ++j) { const float a = fmaxf(v0[j], 0.f), b = fmaxf(v1[j], 0.f); v0[j] = a * a; v1[j] = b * b; }
                    u32x4 w; w.x = cvt_pk_bf16(v0[0], v0[1]); w.y = cvt_pk_bf16(v0[2], v0[3]); w.z = cvt_pk_bf16(v1[0], v1[1]); w.w = cvt_pk_bf16(v1[2], v1[3]);
                    *(u32x4*)(rowp + bj * HALF) = w; } }
    }
};
struct EpiResid {
    static constexpr bool PERM = false, AFTER_DRAIN = false;
    const float* src; float* X; const f32x2* st; const float* g; const float* b; int mode;
    __device__ __forceinline__ void operator()(const f32x4 (&acc)[2][2][4][2], const Unit& u, int wr, int wc, int fr, int fq) const {
        const int row0 = u.pm * BM + wr * 64 + fr, col0 = u.pn * BM + wc * 32 + 4 * fq;
#pragma unroll
        for (int ai = 0; ai < 2; ++ai)
#pragma unroll
            for (int m = 0; m < 4; ++m) { const int row = row0 + ai * HALF + m * 16; const size_t off = (size_t)row * D_ + col0;
                float mu = 0.f, rs = 1.f; if (mode) { const f32x2 s = st[row]; mu = s.x; rs = s.y; }
#pragma unroll
                for (int bj = 0; bj < 2; ++bj)
#pragma unroll
                    for (int n = 0; n < 2; ++n) { const int cc = bj * HALF + n * 16; f32x4 xv = *(const f32x4*)(src + off + cc);
                        if (mode) { const f32x4 gv = *(const f32x4*)(g + col0 + cc), bb = *(const f32x4*)(b + col0 + cc); xv = (xv - mu) * rs * gv + bb; }
                        *(f32x4*)(X + off + cc) = xv * ALPHA + acc[ai][bj][m][n]; }
                asm volatile("" ::: "memory"); }
    }
};
struct EpiQKV {
    static constexpr bool PERM = true, AFTER_DRAIN = false;
    bf16_t* Oq; int ldq; const float* bias; const float* rope; float scale; int rope_tiles; bf16_t* Ov;
    __device__ __forceinline__ void operator()(const f32x4 (&acc)[2][2][4][2], const Unit& u, int wr, int wc, int fr, int fq) const {
        const int row0 = u.pm * BM + wr * 64 + fr, col0 = u.pn * BM + wc * 32 + 8 * fq;
        if (u.pn < rope_tiles) {
#pragma unroll
            for (int ai = 0; ai < 2; ++ai)
#pragma unroll
                for (int m = 0; m < 4; ++m) { const int row = row0 + ai * HALF + m * 16; bf16_t* rowp = Oq + (size_t)row * ldq + col0; const float* rp = rope + (size_t)row * 64;
#pragma unroll
                    for (int bj = 0; bj < 2; ++bj) { unsigned w[4];
#pragma unroll
                        for (int n = 0; n < 2; ++n) { const int c = col0 + bj * HALF + 4 * n, hb = c & ~63, d = (c & 63) >> 1;
                            const f32x2 ba = *(const f32x2*)(bias + hb + d), bb = *(const f32x2*)(bias + hb + 32 + d); const f32x4 cs = *(const f32x4*)(rp + 2 * d);
                            const f32x4 v = acc[ai][bj][m][n];
                            const float t1 = v[0] + ba.x, t2 = v[1] + bb.x, t3 = v[2] + ba.y, t4 = v[3] + bb.y;
                            w[2 * n] = cvt_pk_bf16((t1 * cs[0] - t2 * cs[1]) * scale, (t2 * cs[0] + t1 * cs[1]) * scale);
                            w[2 * n + 1] = cvt_pk_bf16((t3 * cs[2] - t4 * cs[3]) * scale, (t4 * cs[2] + t3 * cs[3]) * scale); }
                        *(u32x4*)(rowp + bj * HALF) = (u32x4){w[0], w[1], w[2], w[3]}; } }
        } else {
            const int vc0 = col0 - rope_tiles * BM;
#pragma unroll
            for (int ai = 0; ai < 2; ++ai)
#pragma unroll
                for (int m = 0; m < 4; ++m) { bf16_t* rowp = Ov + (size_t)(row0 + ai * HALF + m * 16) * 256 + vc0;
#pragma unroll
                    for (int bj = 0; bj < 2; ++bj) { const f32x4 v0 = acc[ai][bj][m][0] + *(const f32x4*)(bias + col0 + bj * HALF), v1 = acc[ai][bj][m][1] + *(const f32x4*)(bias + col0 + bj * HALF + 4);
                        u32x4 w; w.x = cvt_pk_bf16(v0[0], v0[1]); w.y = cvt_pk_bf16(v0[2], v0[3]); w.z = cvt_pk_bf16(v1[0], v1[1]); w.w = cvt_pk_bf16(v1[2], v1[3]);
                        *(u32x4*)(rowp + bj * HALF) = w; } }
        }
    }
};

template <class Epi, class Sched, bool ALIGN_EPI = false, bool SP2 = false>
__device__ __forceinline__ void gemm_phase(LAS unsigned char* lds, const Gemm g, const Sched& S, const Epi& E) {
    int tid = threadIdx.x; asm volatile("" : "+v"(tid));
    const int wid = __builtin_amdgcn_readfirstlane(tid >> 6), lane = tid & 63, wr = wid >> 2, wc = wid & 3, fr = lane & 15, fq = lane >> 4;
    const int K = g.K, nt = K / BK;
    unsigned voffA[2], voffB[2];
#pragma unroll
    for (int i = 0; i < 2; ++i) { int R, C; stage_rc(tid * 16 + i * 8192, R, C); const int Rb = Epi::PERM ? ((R & ~31) + perm32(R & 31)) : R;
        voffA[i] = (unsigned)(R * K + C) * 2u; voffB[i] = (unsigned)(Rb * K + C) * 2u; }
    const size_t kstep = (size_t)(BK * 2);
    const size_t hstep = (size_t)HALF * K * 2;
    const size_t tstep = 2 * hstep;
    const unsigned ldsw = (unsigned)wid * 1024u;
    const int aoff = lds_byte(wr * 64 + fr, fq * 8), boff = lds_byte(wc * 32 + fr, fq * 8);
#define PG8_SA(b, h) (((b) * 2 + (h)) * HTB)
#define PG8_SB(b, h) ((4 + (b) * 2 + (h)) * HTB)
#define PG8_STAGE(bufoff, gbase, voff) do { _Pragma("unroll") for (int _i = 0; _i < 2; ++_i) \
        __builtin_amdgcn_global_load_lds((const unsigned*)((const char*)(gbase) + (voff)[_i]), (LAS unsigned*)(lds + (bufoff) + ldsw + _i * 8192), 16, 0, 0); } while (0)
#define PG8_LDA(dst, b, h) do { _Pragma("unroll") for (int m = 0; m < 4; ++m) _Pragma("unroll") for (int k = 0; k < 2; ++k) dst[m][k] = *(const LAS bf16x8*)(lds + PG8_SA(b, h) + aoff + m * 2048 + k * 1024); } while (0)
#define PG8_LDB(dst, b, h) do { _Pragma("unroll") for (int n = 0; n < 2; ++n) _Pragma("unroll") for (int k = 0; k < 2; ++k) dst[n][k] = *(const LAS bf16x8*)(lds + PG8_SB(b, h) + boff + n * 2048 + k * 1024); } while (0)
#define PG8_MMA(ai, bj, At, Bt) do { __builtin_amdgcn_s_setprio(1); _Pragma("unroll") for (int m = 0; m < 4; ++m) _Pragma("unroll") for (int n = 0; n < 2; ++n) _Pragma("unroll") for (int k = 0; k < 2; ++k) \
        acc[ai][bj][m][n] = __builtin_amdgcn_mfma_f32_16x16x32_bf16(Bt[n][k], At[m][k], acc[ai][bj][m][n], 0, 0, 0); __builtin_amdgcn_s_setprio(0); } while (0)
#define PG8_WAIT_V(n) asm volatile("s_waitcnt vmcnt(" #n ")" ::: "memory")
#define PG8_WAIT_L(n) asm volatile("s_waitcnt lgkmcnt(" #n ")" ::: "memory")
#define PG8_BAR __builtin_amdgcn_s_barrier()
#define PG8_SCHED __builtin_amdgcn_sched_barrier(0)
    Unit cur, nxt; int ui = 0;
    if (!S.next(0, cur)) return;
    f32x4 acc[2][2][4][2];
#pragma unroll
    for (int a = 0; a < 2; ++a)
#pragma unroll
        for (int b = 0; b < 2; ++b)
#pragma unroll
            for (int m = 0; m < 4; ++m)
#pragma unroll
                for (int n = 0; n < 2; ++n) acc[a][b][m][n] = (f32x4){0.f, 0.f, 0.f, 0.f};
    bf16x8 At[4][2], B0[2][2], B1[2][2];
    const char* cA = (const char*)g.A + (size_t)cur.pm * tstep; const char* cB = (const char*)g.Bt + (size_t)cur.pn * tstep;
    S.a_ready(cur);
    if constexpr (SP2) {
        PG8_STAGE(PG8_SB(0, 0), cB, voffB); PG8_STAGE(PG8_SB(0, 1), cB + hstep, voffB); PG8_STAGE(PG8_SA(0, 0), cA, voffA); PG8_STAGE(PG8_SA(0, 1), cA + hstep, voffA);
        if (wr == 1) PG8_BAR;
        PG8_WAIT_V(2); PG8_BAR;
        PG8_STAGE(PG8_SB(1, 0), cB + kstep, voffB); PG8_STAGE(PG8_SA(1, 0), cA + kstep, voffA); PG8_STAGE(PG8_SB(1, 1), cB + hstep + kstep, voffB);
        PG8_WAIT_V(6); PG8_BAR;
    } else {
        PG8_STAGE(PG8_SB(0, 0), cB, voffB); PG8_STAGE(PG8_SA(0, 0), cA, voffA); PG8_STAGE(PG8_SB(0, 1), cB + hstep, voffB); PG8_STAGE(PG8_SA(0, 1), cA + hstep, voffA);
        if (wr == 1) PG8_BAR;
        PG8_WAIT_V(4); PG8_BAR;
        PG8_STAGE(PG8_SB(1, 0), cB + kstep, voffB); PG8_STAGE(PG8_SA(1, 0), cA + kstep, voffA); PG8_STAGE(PG8_SB(1, 1), cB + hstep + kstep, voffB);
        PG8_WAIT_V(6); PG8_BAR;
    }
    for (;;) {
        const bool has_next = S.next(ui + 1, nxt);
        const char* nA = has_next ? (const char*)g.A + (size_t)nxt.pm * tstep : cA; const char* nB = has_next ? (const char*)g.Bt + (size_t)nxt.pn * tstep : cB;
        for (int t = 0; t < nt; t += 2) {
            const bool last = (t == nt - 2);
            const char* a1 = cA + (size_t)(t + 1) * kstep;
            const char* a2 = last ? nA : cA + (size_t)(t + 2) * kstep; const char* b2 = last ? nB : cB + (size_t)(t + 2) * kstep;
            const char* a3 = a2 + kstep; const char* b3 = b2 + kstep;
            if (last && has_next) S.a_ready(nxt);
            if constexpr (SP2) {
            PG8_LDB(B0, 0, 0); PG8_LDB(B1, 0, 1); PG8_SCHED; PG8_LDA(At, 0, 0); PG8_STAGE(PG8_SA(1, 1), a1 + hstep, voffA);
            PG8_WAIT_V(8); PG8_WAIT_L(0); PG8_BAR; PG8_MMA(0, 0, At, B0); PG8_MMA(0, 1, At, B1); PG8_BAR; PG8_SCHED;
            PG8_LDA(At, 0, 1); PG8_STAGE(PG8_SB(0, 0), b2, voffB); PG8_STAGE(PG8_SB(0, 1), b2 + hstep, voffB); PG8_STAGE(PG8_SA(0, 0), a2, voffA);
            PG8_WAIT_V(8); PG8_WAIT_L(0); PG8_BAR; PG8_MMA(1, 0, At, B0); PG8_MMA(1, 1, At, B1); PG8_BAR; PG8_SCHED;
            PG8_LDB(B0, 1, 0); PG8_LDB(B1, 1, 1); PG8_SCHED; PG8_LDA(At, 1, 0); PG8_STAGE(PG8_SA(0, 1), a2 + hstep, voffA);
            PG8_WAIT_V(8); PG8_WAIT_L(0); PG8_BAR; PG8_MMA(0, 0, At, B0); PG8_MMA(0, 1, At, B1); PG8_BAR; PG8_SCHED;
            PG8_LDA(At, 1, 1); PG8_STAGE(PG8_SB(1, 0), b3, voffB); PG8_STAGE(PG8_SB(1, 1), b3 + hstep, voffB); PG8_STAGE(PG8_SA(1, 0), a3, voffA);
            PG8_WAIT_V(8); PG8_WAIT_L(0); PG8_BAR; PG8_MMA(1, 0, At, B0); PG8_MMA(1, 1, At, B1); PG8_BAR; PG8_SCHED;
            } else {
            PG8_LDB(B0, 0, 0); PG8_SCHED; PG8_LDA(At, 0, 0); PG8_STAGE(PG8_SA(1, 1), a1 + hstep, voffA);
            PG8_WAIT_L(8); PG8_BAR; PG8_WAIT_L(0); PG8_MMA(0, 0, At, B0); PG8_BAR; PG8_SCHED;
            PG8_LDB(B1, 0, 1); PG8_STAGE(PG8_SB(0, 0), b2, voffB);
            PG8_BAR; PG8_WAIT_L(0); PG8_MMA(0, 1, At, B1); PG8_BAR;
            PG8_LDA(At, 0, 1); PG8_STAGE(PG8_SA(0, 0), a2, voffA);
            PG8_BAR; PG8_WAIT_L(0); PG8_MMA(1, 0, At, B0); PG8_BAR; PG8_SCHED;
            PG8_STAGE(PG8_SB(0, 1), b2 + hstep, voffB);
            PG8_WAIT_V(6); PG8_BAR; PG8_MMA(1, 1, At, B1); PG8_BAR;
            PG8_LDB(B0, 1, 0); PG8_SCHED; PG8_LDA(At, 1, 0); PG8_STAGE(PG8_SA(0, 1), a2 + hstep, voffA);
            PG8_WAIT_L(8); PG8_BAR; PG8_WAIT_L(0); PG8_MMA(0, 0, At, B0); PG8_BAR; PG8_SCHED;
            PG8_LDB(B1, 1, 1); PG8_STAGE(PG8_SB(1, 0), b3, voffB);
            PG8_BAR; PG8_WAIT_L(0); PG8_MMA(0, 1, At, B1); PG8_BAR;
            PG8_LDA(At, 1, 1); PG8_STAGE(PG8_SA(1, 0), a3, voffA);
            PG8_BAR; PG8_WAIT_L(0); PG8_MMA(1, 0, At, B0); PG8_BAR; PG8_SCHED;
            PG8_STAGE(PG8_SB(1, 1), b3 + hstep, voffB);
            PG8_WAIT_V(6); PG8_BAR; PG8_MMA(1, 1, At, B1); PG8_BAR;
            }
        }
        if constexpr (ALIGN_EPI) { if (wr == 0) PG8_BAR; }
        E(acc, cur, wr, wc, fr, fq); S.done(cur);
        if (!has_next) break;
#pragma unroll
        for (int a = 0; a < 2; ++a)
#pragma unroll
            for (int b = 0; b < 2; ++b)
#pragma unroll
                for (int m = 0; m < 4; ++m)
#pragma unroll
                    for (int n = 0; n < 2; ++n) acc[a][b][m][n] = (f32x4){0.f, 0.f, 0.f, 0.f};
        cur = nxt; cA = nA; cB = nB; ++ui;
        if constexpr (ALIGN_EPI) { if (wr == 1) PG8_BAR; }
    }
    PG8_WAIT_V(0);
    if constexpr (!ALIGN_EPI) { if (wr == 0) PG8_BAR; }
    PG8_BAR;
#undef PG8_SA
#undef PG8_SB
#undef PG8_STAGE
#undef PG8_LDA
#undef PG8_LDB
#undef PG8_MMA
#undef PG8_WAIT_V
#undef PG8_WAIT_L
#undef PG8_BAR
#undef PG8_SCHED
}
}

__device__ __forceinline__ int opaque_tid() { int t = threadIdx.x; asm volatile("" : "+v"(t)); return t; }
#define LDS_WAIT() asm volatile("s_waitcnt lgkmcnt(0)" ::: "memory")
__device__ __forceinline__ float wave_sum(float v) {
#pragma unroll
    for (int o = 1; o < 64; o <<= 1) v += __shfl_xor(v, o);
    return v;
}
__device__ __forceinline__ bf16x8 tr_read2(unsigned a0, unsigned a1) {
    s16x4 r0, r1;
    asm volatile("ds_read_b64_tr_b16 %0, %2\n\tds_read_b64_tr_b16 %1, %3\n\ts_waitcnt lgkmcnt(0)" : "=&v"(r0), "=&v"(r1) : "v"(a0), "v"(a1) : "memory");
    return (bf16x8){r0[0], r0[1], r0[2], r0[3], r1[0], r1[1], r1[2], r1[3]};
}

__device__ __forceinline__ void xpose_item(const float* W, int K, int N, bf16_t* WT, int perm_limit, LAS float* scr, int item, int lane) {
    const int nblk = N >> 5, kb = item / nblk, nb = item - kb * nblk, k0 = 64 * kb, n0 = 32 * nb;
    float v[32];
    const float* src = W + (size_t)(k0 + (lane >> 5)) * N + n0 + (lane & 31);
#pragma unroll
    for (int i = 0; i < 32; ++i) v[i] = src[(size_t)(2 * i) * N];
#pragma unroll
    for (int i = 0; i < 32; ++i) scr[(2 * i + (lane >> 5)) * 33 + (lane & 31)] = v[i];
    LDS_WAIT(); asm volatile("" ::: "memory");
    const int c = lane & 7;
#pragma unroll
    for (int j = 0; j < 4; ++j) { const int n = (lane >> 3) + 8 * j; const LAS float* s = scr + (8 * c) * 33 + n;
        u32x4 o; o.x = cvt_pk_bf16(s[0 * 33], s[1 * 33]); o.y = cvt_pk_bf16(s[2 * 33], s[3 * 33]); o.z = cvt_pk_bf16(s[4 * 33], s[5 * 33]); o.w = cvt_pk_bf16(s[6 * 33], s[7 * 33]);
        int nn = n0 + n; if (nn < perm_limit) { const int p = nn & 63; nn = (nn & ~63) + (p < 32 ? 2 * p : 2 * (p - 32) + 1); }
        *(u32x4*)(WT + (size_t)nn * K + k0 + 8 * c) = o; }
    LDS_WAIT(); asm volatile("" ::: "memory");
}

struct Ptrs {
    const float* in[18]; float* out; unsigned char* ws;
};

__device__ __forceinline__ void prologue(const Ptrs& P, LAS unsigned char* lds) {
    const int tid = opaque_tid(), wave = tid >> 6, lane = tid & 63;
    LAS float* scr = (LAS float*)(lds + wave * 16384);
    const int gw = blockIdx.x * 8 + wave, NGW = gridDim.x * 8;
    unsigned char* ws = P.ws;
    for (int it = gw; it < 86528; it += NGW) {
        int r = it; const float* W; bf16_t* WT; int K, N, PL = 0;
        if (r < 8192) { const int l = r >> 12; r &= 4095; W = P.in[1] + (size_t)l * 2048 * 4096; WT = (bf16_t*)(ws + WS_WIN) + (size_t)l * 4096 * 2048; K = 2048; N = 4096; }
        else if (r < 12288) { r -= 8192; const int l = r >> 11; r &= 2047; W = P.in[7] + (size_t)l * 2048 * 2048; WT = (bf16_t*)(ws + WS_WOUT) + (size_t)l * 2048 * 2048; K = 2048; N = 2048; }
        else if (r < 12800) { r -= 12288; W = P.in[8]; WT = (bf16_t*)(ws + WS_WKV); K = 2048; N = 512; PL = 256; }
        else if (r < 16896) { r -= 12800; const int l = r >> 11; r &= 2047; W = P.in[10] + (size_t)l * 2048 * 2048; WT = (bf16_t*)(ws + WS_WQ) + (size_t)l * 2048 * 2048; K = 2048; N = 2048; PL = 2048; }
        else if (r < 20992) { r -= 16896; const int l = r >> 11; r &= 2047; W = P.in[13] + (size_t)l * 2048 * 2048; WT = (bf16_t*)(ws + WS_WO) + (size_t)l * 2048 * 2048; K = 2048; N = 2048; }
        else if (r < 53760) { r -= 20992; const int l = r >> 13; r &= 8191; W = P.in[14] + (size_t)l * 2048 * 8192; WT = (bf16_t*)(ws + WS_WUP) + (size_t)l * 8192 * 2048; K = 2048; N = 8192; }
        else { r -= 53760; const int l = r >> 13; r &= 8191; W = P.in[15] + (size_t)l * 8192 * 2048; WT = (bf16_t*)(ws + WS_WDN) + (size_t)l * 2048 * 8192; K = 8192; N = 2048; }
        xpose_item(W, K, N, WT, PL, scr, r, lane);
    }
    const int gt = blockIdx.x * 512 + tid, NT = gridDim.x * 512;
    { const float* x = P.in[0]; bf16_t* XB = (bf16_t*)(ws + WS_XB);
      for (int i = gt; i < S_ * D_ / 8; i += NT) { const f32x4 a = *(const f32x4*)(x + (size_t)i * 8), b = *(const f32x4*)(x + (size_t)i * 8 + 4);
          u32x4 w; w.x = cvt_pk_bf16(a[0], a[1]); w.y = cvt_pk_bf16(a[2], a[3]); w.z = cvt_pk_bf16(b[0], b[1]); w.w = cvt_pk_bf16(b[2], b[3]); *(u32x4*)(XB + (size_t)i * 8) = w; } }
    { const float* w_s = P.in[5]; bf16_t* WSb = (bf16_t*)(ws + WS_WS);
      for (int i = gt; i < 2 * 8 * 128 * 128 / 8; i += NT) { const int flat = i * 8, j0 = flat & 127, ii = (flat >> 7) & 127; const f32x4 a = *(const f32x4*)(w_s + flat), b = *(const f32x4*)(w_s + flat + 4);
          float v[8] = {a[0], a[1], a[2], a[3], b[0], b[1], b[2], b[3]};
#pragma unroll
          for (int e = 0; e < 8; ++e) v[e] = (j0 + e <= ii) ? v[e] : 0.f;
          u32x4 w; w.x = cvt_pk_bf16(v[0], v[1]); w.y = cvt_pk_bf16(v[2], v[3]); w.z = cvt_pk_bf16(v[4], v[5]); w.w = cvt_pk_bf16(v[6], v[7]); *(u32x4*)(WSb + flat) = w; } }
    { float* rope = (float*)(ws + WS_ROPE);
      for (int i = gt; i < S_ * 32; i += NT) { const int pos = i >> 5, fi = i & 31; const float inv = (float)pow(10000.0, -(double)(2 * fi) / 64.0); const float ang = (float)pos * inv;
          double sn, cs; sincos((double)ang, &sn, &cs); *(f32x2*)(rope + (size_t)i * 2) = (f32x2){(float)cs, (float)sn}; } }
}

template <bool FINAL>
__device__ __forceinline__ void ln_phase(const float* X, const float* g, const float* b, bf16_t* XB, f32x2* ST, float* OUT) {
    const int tid = opaque_tid(), wave = tid >> 6, lane = tid & 63;
    const int gw = blockIdx.x * 8 + wave, NGW = gridDim.x * 8;
    for (int row = gw; row < S_; row += NGW) {
        const f32x4* xr = (const f32x4*)(X + (size_t)row * D_) + lane;
        f32x4 v[8]; float s = 0.f;
#pragma unroll
        for (int j = 0; j < 8; ++j) { v[j] = xr[64 * j]; s += (v[j][0] + v[j][1]) + (v[j][2] + v[j][3]); }
        const float mean = wave_sum(s) * (1.f / D_); float s2 = 0.f;
#pragma unroll
        for (int j = 0; j < 8; ++j) { v[j] = v[j] - mean; s2 += (v[j][0] * v[j][0] + v[j][1] * v[j][1]) + (v[j][2] * v[j][2] + v[j][3] * v[j][3]); }
        const float rstd = 1.f / sqrtf(wave_sum(s2) * (1.f / D_) + LN_EPS);
#pragma unroll
        for (int j = 0; j < 8; ++j) { const int c = 4 * lane + 256 * j; const f32x4 gv = *(const f32x4*)(g + c), bv = *(const f32x4*)(b + c); const f32x4 o = v[j] * rstd * gv + bv;
            if (FINAL) *(f32x4*)(OUT + (size_t)row * D_ + c) = o;
            else { u32x2 w; w.x = cvt_pk_bf16(o[0], o[1]); w.y = cvt_pk_bf16(o[2], o[3]); *(u32x2*)(XB + (size_t)row * D_ + c) = w; } }
        if (!FINAL && lane == 0) ST[row] = (f32x2){mean, rstd};
    }
}

__device__ __forceinline__ void sgu_phase(LAS unsigned char* lds, const bf16_t* Z, const f32x2* vpart, const bf16_t* WSb, const float* bs, const float* gv, const float* bv, bf16_t* Y) {
    constexpr int WST = 136, VST = 264;
    const int tid = opaque_tid(), wid = tid >> 6, lane = tid & 63, fr = lane & 15, fq = lane >> 4;
    LAS bf16_t* Wl = (LAS bf16_t*)lds; LAS bf16_t* Vl = (LAS bf16_t*)(lds + 128 * WST * 2); LAS f32x2* stl = (LAS f32x2*)(lds + 128 * WST * 2 + 128 * VST * 2);
    for (int it = blockIdx.x; it < 1024; it += gridDim.x) {
        const int c = it >> 3, g = it & 7, R0 = c * 128;
        __syncthreads();
        { const int row = tid >> 2, sub = tid & 3; const f32x4* pp = (const f32x4*)(vpart + (size_t)(R0 + row) * 32 + sub * 8); float s = 0.f, q = 0.f;
#pragma unroll
          for (int k = 0; k < 4; ++k) { const f32x4 t = pp[k]; s += t[0] + t[2]; q += t[1] + t[3]; }
          s += __shfl_xor(s, 1); s += __shfl_xor(s, 2); q += __shfl_xor(q, 1); q += __shfl_xor(q, 2);
          const float mean = s * (1.f / 2048.f); float var = q * (1.f / 2048.f) - mean * mean; var = fmaxf(var, 0.f);
          if (sub == 0) stl[row] = (f32x2){mean, 1.f / sqrtf(var + LN_EPS)}; }
#pragma unroll
        for (int i = 0; i < 4; ++i) { const int chunk = tid + 512 * i, r = chunk >> 4, part = chunk & 15;
            *(LAS u32x4*)(Wl + r * WST + part * 8) = *(const u32x4*)(WSb + (size_t)(g * 128 + r) * 128 + part * 8); }
        __syncthreads();
#pragma unroll
        for (int i = 0; i < 8; ++i) { const int chunk = tid + 512 * i, j = chunk >> 5, dg = chunk & 31;
            const u32x4 raw = *(const u32x4*)(Z + (size_t)(R0 + j) * ZW_ + 2048 + g * 256 + dg * 8); const f32x2 st = stl[j];
            const f32x4 g0 = *(const f32x4*)(gv + g * 256 + dg * 8), g1 = *(const f32x4*)(gv + g * 256 + dg * 8 + 4), b0 = *(const f32x4*)(bv + g * 256 + dg * 8), b1 = *(const f32x4*)(bv + g * 256 + dg * 8 + 4);
            const f32x4 x0 = (f32x4){bf_lo(raw.x), bf_hi(raw.x), bf_lo(raw.y), bf_hi(raw.y)}, x1 = (f32x4){bf_lo(raw.z), bf_hi(raw.z), bf_lo(raw.w), bf_hi(raw.w)};
            const f32x4 o0 = (x0 - st.x) * st.y * g0 + b0, o1 = (x1 - st.x) * st.y * g1 + b1;
            u32x4 w; w.x = cvt_pk_bf16(o0[0], o0[1]); w.y = cvt_pk_bf16(o0[2], o0[3]); w.z = cvt_pk_bf16(o1[0], o1[1]); w.w = cvt_pk_bf16(o1[2], o1[3]);
            *(LAS u32x4*)(Vl + j * VST + dg * 8) = w; }
        __syncthreads();
        const int dbase = 32 * wid;
        bf16x8 vf[2][4];
#pragma unroll
        for (int dt = 0; dt < 2; ++dt)
#pragma unroll
            for (int ks = 0; ks < 4; ++ks) { const unsigned a0 = (unsigned)(uintptr_t)(Vl + (32 * ks + 8 * fq + (fr >> 2)) * VST + dbase + 16 * dt + 4 * (fr & 3));
                vf[dt][ks] = tr_read2(a0, a0 + 4 * VST * 2); }
#pragma unroll
        for (int ti = 0; ti < 8; ++ti) {
            f32x4 acc[2] = {(f32x4){0.f, 0.f, 0.f, 0.f}, (f32x4){0.f, 0.f, 0.f, 0.f}};
#pragma unroll
            for (int ks = 0; ks < 4; ++ks) if (ks <= ((16 * ti + 15) >> 5)) {
                const bf16x8 wf = *(const LAS bf16x8*)(Wl + (16 * ti + fr) * WST + 32 * ks + 8 * fq);
#pragma unroll
                for (int dt = 0; dt < 2; ++dt) acc[dt] = __builtin_amdgcn_mfma_f32_16x16x32_bf16(vf[dt][ks], wf, acc[dt], 0, 0, 0); }
            const int i = 16 * ti + fr, row = R0 + i; const float bsv = bs[g * 128 + i];
#pragma unroll
            for (int dt = 0; dt < 2; ++dt) { const int d = g * 256 + dbase + 16 * dt + 4 * fq; const u32x2 uu = *(const u32x2*)(Z + (size_t)row * ZW_ + d);
                const f32x4 sv = acc[dt] + bsv; u32x2 w; w.x = cvt_pk_bf16(bf_lo(uu.x) * sv[0], bf_hi(uu.x) * sv[1]); w.y = cvt_pk_bf16(bf_lo(uu.y) * sv[2], bf_hi(uu.y) * sv[3]);
                *(u32x2*)(Y + (size_t)row * D_ + d) = w; }
        }
    }
}

__device__ __forceinline__ void attn_phase(LAS unsigned char* lds, const bf16_t* Q, const bf16_t* Kb, const bf16_t* Vb, const float* sinks, bf16_t* O) {
    constexpr int KS = 72;
    const int tid = opaque_tid(), wid = tid >> 6, lane = tid & 63, fr = lane & 15, fq = lane >> 4;
    LAS bf16_t* Kl = (LAS bf16_t*)lds; LAS bf16_t* Vl = (LAS bf16_t*)(lds + 256 * KS * 2);
    for (int it = blockIdx.x; it < 512; it += gridDim.x) {
        const int nb = it >> 2, hkv = it & 3;
        __syncthreads();
#pragma unroll
        for (int i = 0; i < 4; ++i) { const int chunk = tid + 512 * i, row = chunk >> 3, part = chunk & 7, pos = (nb - 1) * 128 + row;
            u32x4 kv = (u32x4){0u, 0u, 0u, 0u}, vv = (u32x4){0u, 0u, 0u, 0u};
            if (pos >= 0) { kv = *(const u32x4*)(Kb + (size_t)pos * 256 + hkv * 64 + part * 8); vv = *(const u32x4*)(Vb + (size_t)pos * 256 + hkv * 64 + part * 8); }
            *(LAS u32x4*)(Kl + row * KS + part * 8) = kv; *(LAS u32x4*)(Vl + row * KS + part * 8) = vv; }
        __syncthreads();
        const int hq = hkv * 8 + wid; const float sink = sinks[hq];
        for (int a = 0; a < 8; ++a) {
            const int qpos = nb * 128 + 16 * a + fr;
            const bf16x8 qf0 = *(const bf16x8*)(Q + (size_t)qpos * D_ + hq * 64 + 8 * fq), qf1 = *(const bf16x8*)(Q + (size_t)qpos * D_ + hq * 64 + 32 + 8 * fq);
            const int kt0 = a & ~1;
            f32x4 sc[10];
#pragma unroll
            for (int t = 0; t < 10; ++t) { const int key = 16 * (kt0 + t) + fr;
                const bf16x8 k0 = *(const LAS bf16x8*)(Kl + key * KS + 8 * fq), k1 = *(const LAS bf16x8*)(Kl + key * KS + 32 + 8 * fq);
                f32x4 cacc = (f32x4){0.f, 0.f, 0.f, 0.f};
                cacc = __builtin_amdgcn_mfma_f32_16x16x32_bf16(k0, qf0, cacc, 0, 0, 0); cacc = __builtin_amdgcn_mfma_f32_16x16x32_bf16(k1, qf1, cacc, 0, 0, 0); sc[t] = cacc; }
            const int qi = 16 * a + fr; float mx = sink;
#pragma unroll
            for (int t = 0; t < 10; ++t)
#pragma unroll
                for (int e = 0; e < 4; ++e) { const int j = 16 * (kt0 + t) + 4 * fq + e; const bool valid = (j > qi) && (j <= qi + 128) && (nb > 0 || j >= 128);
                    const float v = valid ? sc[t][e] : -__builtin_inff(); sc[t][e] = v; mx = fmaxf(mx, v); }
            mx = fmaxf(mx, __shfl_xor(mx, 16)); mx = fmaxf(mx, __shfl_xor(mx, 32));
            float l = 0.f;
#pragma unroll
            for (int t = 0; t < 10; ++t)
#pragma unroll
                for (int e = 0; e < 4; ++e) { const float p = __builtin_amdgcn_exp2f((sc[t][e] - mx) * LOG2E); sc[t][e] = p; l += p; }
            l += __shfl_xor(l, 16); l += __shfl_xor(l, 32);
            const float inv = 1.f / (l + __builtin_amdgcn_exp2f((sink - mx) * LOG2E));
            f32x4 o[4];
#pragma unroll
            for (int dt = 0; dt < 4; ++dt) o[dt] = (f32x4){0.f, 0.f, 0.f, 0.f};
#pragma unroll
            for (int pp = 0; pp < 5; ++pp) {
                union { u32x4 u; bf16x8 h; } pf;
                pf.u.x = cvt_pk_bf16(sc[2 * pp][0], sc[2 * pp][1]); pf.u.y = cvt_pk_bf16(sc[2 * pp][2], sc[2 * pp][3]);
                pf.u.z = cvt_pk_bf16(sc[2 * pp + 1][0], sc[2 * pp + 1][1]); pf.u.w = cvt_pk_bf16(sc[2 * pp + 1][2], sc[2 * pp + 1][3]);
                const int kb = 16 * (kt0 + 2 * pp);
#pragma unroll
                for (int dt = 0; dt < 4; ++dt) { const unsigned a0 = (unsigned)(uintptr_t)(Vl + (kb + 4 * fq + (fr >> 2)) * KS + 16 * dt + 4 * (fr & 3));
                    const bf16x8 vf = tr_read2(a0, a0 + 16 * KS * 2); o[dt] = __builtin_amdgcn_mfma_f32_16x16x32_bf16(vf, pf.h, o[dt], 0, 0, 0); }
            }
#pragma unroll
            for (int dt = 0; dt < 4; ++dt) { const f32x4 ov = o[dt] * inv; u32x2 w; w.x = cvt_pk_bf16(ov[0], ov[1]); w.y = cvt_pk_bf16(ov[2], ov[3]);
                *(u32x2*)(O + (size_t)qpos * D_ + hq * 64 + 16 * dt + 4 * fq) = w; }
        }
    }
}

struct Args { const float* in[18]; float* out; unsigned char* ws; int ph_lo, ph_hi; };
constexpr int N_PHASES = 29;

__global__ void __launch_bounds__(512, 2) mk_fwd(Args a) {
    extern __shared__ __attribute__((aligned(16))) unsigned char lds_raw[];
    LAS unsigned char* lds = (LAS unsigned char*)lds_raw;
    cg::grid_group grid = cg::this_grid();
    unsigned char* ws = a.ws;
    bf16_t* XB = (bf16_t*)(ws + WS_XB); f32x2* ST = (f32x2*)(ws + WS_ST); float* X = a.out;
    bf16_t* Yb = (bf16_t*)(ws + WS_Y); bf16_t* Hb = (bf16_t*)(ws + WS_H); bf16_t* Zb = Hb; bf16_t* Qb = Hb;
    const float* ln_g = a.in[16]; const float* ln_b = a.in[17];
    const int G = gridDim.x, bx = blockIdx.x;
    {
        Ptrs P; for (int i = 0; i < 18; ++i) P.in[i] = a.in[i]; P.out = a.out; P.ws = a.ws;
        if (EN_PRO) prologue(P, lds);
    }
    grid.sync();
    for (int layer = 0; layer < 4; ++layer) {
        if (layer < 2) {
            { pg8::Gemm g{XB, (const bf16_t*)(ws + WS_WIN) + (size_t)layer * 4096 * 2048, S_, ZW_, D_}; pg8::StaticOrder So; So.init(S_, ZW_, G, bx);
              pg8::EpiGeluZ E{Zb, a.in[2] + layer * 4096, (f32x2*)(ws + WS_VPART)};
              if (EN_IN) pg8::gemm_phase<pg8::EpiGeluZ, pg8::StaticOrder, true, true>(lds, g, So, E); }
            grid.sync();
            if (EN_SGU) sgu_phase(lds, Zb, (const f32x2*)(ws + WS_VPART), (const bf16_t*)(ws + WS_WS) + (size_t)layer * 8 * 128 * 128, a.in[6] + layer * 1024, a.in[3] + layer * 2048, a.in[4] + layer * 2048, Yb);
        } else {
            const int j = layer - 2;
            for (int pass = 0; pass < (j == 0 ? 2 : 1); ++pass) {
                pg8::Gemm g{XB, pass == 0 ? (const bf16_t*)(ws + WS_WQ) + (size_t)j * 2048 * 2048 : (const bf16_t*)(ws + WS_WKV), S_, pass == 0 ? D_ : 512, D_};
                pg8::StaticOrder So; So.init(S_, pass == 0 ? D_ : 512, G, bx);
                pg8::EpiQKV E{pass == 0 ? Qb : (bf16_t*)(ws + WS_KB), pass == 0 ? D_ : 256, pass == 0 ? a.in[11] + j * 2048 : a.in[9], (const float*)(ws + WS_ROPE), pass == 0 ? 0.125f : 1.0f, pass == 0 ? 8 : 1, (bf16_t*)(ws + WS_VB)};
                if (EN_QKV) pg8::gemm_phase<pg8::EpiQKV, pg8::StaticOrder, true, true>(lds, g, So, E);
            }
            grid.sync();
            if (EN_ATT) attn_phase(lds, Qb, (const bf16_t*)(ws + WS_KB), (const bf16_t*)(ws + WS_VB), a.in[12] + j * 32, Yb);
        }
        grid.sync();
        for (int half = 0; half < 2; ++half) {
            {
                const bf16_t* Wt = half ? (const bf16_t*)(ws + WS_WDN) + (size_t)layer * 2048 * 8192
                                        : (layer < 2 ? (const bf16_t*)(ws + WS_WOUT) + (size_t)layer * 2048 * 2048 : (const bf16_t*)(ws + WS_WO) + (size_t)(layer - 2) * 2048 * 2048);
                pg8::Gemm g{half ? Hb : Yb, Wt, S_, D_, half ? FF_ : D_}; pg8::StaticOrder So; So.init(S_, D_, G, bx);
                const int raw = (half == 0 && layer == 0);
                const int pl = half ? layer * 2 : (layer > 0 ? (layer - 1) * 2 + 1 : 0);
                pg8::EpiResid E{raw ? a.in[0] : (const float*)X, X, ST, ln_g + pl * 2048, ln_b + pl * 2048, raw ? 0 : 1};
                if (EN_RES) pg8::gemm_phase<pg8::EpiResid, pg8::StaticOrder, true, true>(lds, g, So, E);
            }
            grid.sync();
            const int li = layer * 2 + half;
            if (!EN_LN) {} else if (li == 7) ln_phase<true>(X, ln_g + li * 2048, ln_b + li * 2048, nullptr, nullptr, X);
            else ln_phase<false>(X, ln_g + li * 2048, ln_b + li * 2048, XB, ST, nullptr);
            if (li != 7) grid.sync();
            if (half == 0) {
                pg8::Gemm g{XB, (const bf16_t*)(ws + WS_WUP) + (size_t)layer * 8192 * 2048, S_, FF_, D_}; pg8::StaticOrder So; So.init(S_, FF_, G, bx);
                pg8::EpiRelu2 E{Hb};
                if (EN_UP) pg8::gemm_phase<pg8::EpiRelu2, pg8::StaticOrder, true, true>(lds, g, So, E);
                grid.sync();
            }
        }
    }
}

extern "C" void kernel_launch(void* const* d_in, const int* in_sizes, int n_in, void* d_out, int out_size, void* d_ws, size_t ws_size, hipStream_t stream) {
    static int grid = 0;
    if (grid == 0) {
        if (n_in != 18 || out_size != S_ * D_ || ws_size < WS_END) { fprintf(stderr, "kernel_launch: unexpected shapes (n_in %d out %d ws %zu need %zu)\n", n_in, out_size, ws_size, (size_t)WS_END); grid = -1; return; }
        int dev = 0, cus = 0, per_cu = 0;
        hipGetDevice(&dev);
        hipDeviceGetAttribute(&cus, hipDeviceAttributeMultiprocessorCount, dev);
        if (hipFuncSetAttribute((const void*)mk_fwd, hipFuncAttributeMaxDynamicSharedMemorySize, LDS_BYTES) != hipSuccess) { fprintf(stderr, "kernel_launch: hipFuncSetAttribute failed\n"); grid = -1; return; }
        if (hipOccupancyMaxActiveBlocksPerMultiprocessor(&per_cu, (const void*)mk_fwd, 512, LDS_BYTES) != hipSuccess || per_cu < 1) { fprintf(stderr, "kernel_launch: occupancy query says %d\n", per_cu); per_cu = 1; }
        (void)hipGetLastError();
        grid = cus;
    }
    if (grid < 0) return;
    Args a{};
    for (int i = 0; i < 18; ++i) a.in[i] = (const float*)d_in[i];
    a.out = (float*)d_out; a.ws = (unsigned char*)d_ws; a.ph_lo = 0; a.ph_hi = N_PHASES;
    void* args[] = {&a};
    hipError_t e = hipLaunchCooperativeKernel((const void*)mk_fwd, dim3(grid), dim3(512), args, LDS_BYTES, stream);
    if (e != hipSuccess) fprintf(stderr, "kernel_launch: cooperative launch failed: %s (grid %d)\n", hipGetErrorString(e), grid);
}
```
